# Optimizing an MI355X kernel written in HIP

```python
import jax, jax.numpy as jnp
from jax import lax
import numpy as np

D_MODEL = 1024
BATCH = 8
SEQ = 2048
DEPTH = 4

GRID_W = 64
CTX_LEN = 256
EPS = 1e-6
NEG_BIG = -1e30
LB_FLOOR = 1e-30

N_BRANCH = 3
BRANCH_WIDTH = D_MODEL // 2

FOURIER_GROUPS = 4
FOURIER_WIDTH = BRANCH_WIDTH
FOURIER_GROUP_DIM = FOURIER_WIDTH // FOURIER_GROUPS

HEAD_DIM = 64
ATTN_HEADS = BRANCH_WIDTH // HEAD_DIM
ATTN_KV_HEADS = ATTN_HEADS // 4
ATTN_WIDTH = ATTN_HEADS * HEAD_DIM
KV_WIDTH = ATTN_KV_HEADS * HEAD_DIM
WINDOW = 128
BLOCK = 128
ROPE_THETA = 10000.0

HGRN_HEADS = 4
HGRN_DK = BRANCH_WIDTH // HGRN_HEADS
HGRN_DV = BRANCH_WIDTH // HGRN_HEADS
HGRN_KW = HGRN_HEADS * HGRN_DK
HGRN_VW = HGRN_HEADS * HGRN_DV
CHUNK = 64

D_FF = 4 * D_MODEL

_SEG_SIZES = (KV_WIDTH, KV_WIDTH, HGRN_VW, HGRN_KW, HGRN_KW,
              ATTN_WIDTH, HGRN_KW, HGRN_VW, FOURIER_WIDTH, N_BRANCH * D_MODEL)
IN_SPLITS = [sum(_SEG_SIZES[:i + 1]) for i in range(len(_SEG_SIZES) - 1)]
D_IN = sum(_SEG_SIZES)
N_STATE_COLS = sum(_SEG_SIZES[:5])
STATE_SPLITS = IN_SPLITS[:4]

kernel_name = "hybrid_fourier_swa_hgrn2_dit_prefix"

F32 = jnp.float32


def rms_norm(x, g):
    xf = x.astype(F32)
    y = xf * lax.rsqrt(jnp.mean(xf * xf, axis=-1, keepdims=True) + EPS)
    return (y * g.astype(F32)).astype(x.dtype)


def adaln_norm(x, g, shift, scale):
    return rms_norm(x, g) * (1 + scale) + shift


def modulation(cond, w, b):
    m = jax.nn.silu(cond) @ w + b
    return jnp.split(m, 6, axis=-1)


def _heads(a, n):
    return a.reshape(a.shape[:-1] + (n, a.shape[-1] // n))


def _to_bhtd(a, n):
    return jnp.swapaxes(_heads(a, n), 1, 2)


def _flip_t(a):
    return jnp.flip(a, axis=2)


def axial_rope_tables(n_tok):
    n_rows = n_tok // GRID_W
    row = jnp.repeat(jnp.arange(n_rows), GRID_W).astype(F32)
    col = jnp.tile(jnp.arange(GRID_W), n_rows).astype(F32)
    axis_dim = HEAD_DIM // 2
    inv_freq = ROPE_THETA ** (-jnp.arange(0, axis_dim, 2, dtype=F32) / axis_dim)
    ang_r = row[:, None] * inv_freq
    ang_c = col[:, None] * inv_freq
    return (jnp.cos(ang_r), jnp.sin(ang_r), jnp.cos(ang_c), jnp.sin(ang_c))


def apply_axial_rope(t, rope):
    cos_r, sin_r, cos_c, sin_c = rope

    def rot(u, cos, sin):
        u1, u2 = jnp.split(u, 2, axis=-1)
        cos = cos[None, :, None, :]
        sin = sin[None, :, None, :]
        return jnp.concatenate([u1 * cos - u2 * sin, u2 * cos + u1 * sin], axis=-1)

    tr, tc = jnp.split(t, 2, axis=-1)
    return jnp.concatenate([rot(tr, cos_r, sin_r), rot(tc, cos_c, sin_c)], axis=-1).astype(t.dtype)


def _sink_column(sink, ref):
    g = ATTN_HEADS // ATTN_KV_HEADS
    return jnp.broadcast_to(sink.astype(F32).reshape(ATTN_KV_HEADS, g, 1, 1), ref.shape[:-1] + (1,))


def window_attention(q, k, v, kc, vc, sink):
    b, s, _, dh = q.shape
    nb = s // BLOCK
    g = ATTN_HEADS // ATTN_KV_HEADS
    scale = dh ** -0.5
    qb = q.reshape(b, nb, BLOCK, ATTN_KV_HEADS, g, dh)
    pad = ((0, 0), (BLOCK, BLOCK), (0, 0), (0, 0))
    kp = jnp.pad(k, pad).reshape(b, nb + 2, BLOCK, ATTN_KV_HEADS, dh)
    vp = jnp.pad(v, pad).reshape(b, nb + 2, BLOCK, ATTN_KV_HEADS, dh)
    kw = jnp.concatenate([kp[:, :-2], kp[:, 1:-1], kp[:, 2:]], axis=2)
    vw = jnp.concatenate([vp[:, :-2], vp[:, 1:-1], vp[:, 2:]], axis=2)
    s_win = jnp.einsum('bnqhgd,bnkhd->bnhgqk', qb, kw).astype(F32) * scale
    s_ctx = jnp.einsum('bnqhgd,bchd->bnhgqc', qb, kc).astype(F32) * scale
    t_pos = jnp.arange(nb)[:, None, None] * BLOCK + jnp.arange(BLOCK)[None, :, None]
    k_pos = jnp.arange(nb)[:, None, None] * BLOCK - BLOCK + jnp.arange(3 * BLOCK)[None, None, :]
    valid = (jnp.abs(k_pos - t_pos) <= WINDOW) & (k_pos >= 0) & (k_pos < s)
    s_win = jnp.where(valid[None, :, None, None], s_win, NEG_BIG)
    logits = jnp.concatenate([s_win, s_ctx, _sink_column(sink, s_win)], axis=-1)
    p = jax.nn.softmax(logits, axis=-1)
    nw = 3 * BLOCK
    nc = kc.shape[1]
    o = (jnp.einsum('bnhgqk,bnkhd->bnqhgd', p[..., :nw].astype(v.dtype), vw)
         + jnp.einsum('bnhgqc,bchd->bnqhgd', p[..., nw:nw + nc].astype(v.dtype), vc))
    return o.reshape(b, s, ATTN_HEADS * dh)


def context_attention(qc, kc, vc, sink):
    b, lc, _, dh = qc.shape
    g = ATTN_HEADS // ATTN_KV_HEADS
    qg = qc.reshape(b, lc, ATTN_KV_HEADS, g, dh)
    s = jnp.einsum('bqhgd,bkhd->bhgqk', qg, kc).astype(F32) * dh ** -0.5
    p = jax.nn.softmax(jnp.concatenate([s, _sink_column(sink, s)], axis=-1), axis=-1)
    o = jnp.einsum('bhgqk,bkhd->bqhgd', p[..., :lc].astype(vc.dtype), vc)
    return o.reshape(b, lc, ATTN_HEADS * dh)


def fourier_mix(a):
    b, t, _ = a.shape
    ag = a.astype(F32).reshape(b, t, FOURIER_GROUPS, FOURIER_GROUP_DIM)
    y = jnp.fft.fft2(ag, axes=(1, 3), norm='ortho').real
    return y.reshape(b, t, FOURIER_WIDTH).astype(a.dtype)


def hgrn_forget(z, lb):
    zf = z.astype(F32)
    lbf = lb.astype(F32)
    k = (1.0 - lbf) * jax.nn.sigmoid(-zf)
    logf = jnp.logaddexp(jax.nn.log_sigmoid(zf),
                         jnp.log(jnp.maximum(lbf, LB_FLOOR)) + jax.nn.log_sigmoid(-zf))
    return k, logf


def hgrn_kv(i_raw, ff_raw, fb_raw, lb):
    v = _to_bhtd(i_raw.astype(F32), HGRN_HEADS)
    kf, lff = hgrn_forget(ff_raw, lb[0])
    kb, lfb = hgrn_forget(fb_raw, lb[1])
    return (v, _to_bhtd(kf, HGRN_HEADS), _to_bhtd(lff, HGRN_HEADS),
            _to_bhtd(kb, HGRN_HEADS), _to_bhtd(lfb, HGRN_HEADS))


def hgrn_q(q_raw):
    return _to_bhtd(jax.nn.silu(q_raw).astype(F32), HGRN_HEADS)


def gla_chunked(q, k, v, logf, s0):
    b, h, t, dk = q.shape
    dv = v.shape[-1]
    n = t // CHUNK

    def to_chunks(a):
        return jnp.moveaxis(a.reshape(b, h, n, CHUNK, a.shape[-1]), 2, 0)

    lower = jnp.tril(jnp.ones((CHUNK, CHUNK), dtype=bool))[:, :, None]

    def step(state, inp):
        qc, kc, vc, lc = inp
        g = jnp.cumsum(lc, axis=2)
        o_inter = jnp.einsum('bhtk,bhkv->bhtv', qc * jnp.exp(g), state)
        diff = g[:, :, :, None, :] - g[:, :, None, :, :]
        decay = jnp.where(lower, jnp.exp(jnp.where(lower, diff, 0.0)), 0.0)
        a = jnp.einsum('bhtsk,bhsk->bhts', qc[:, :, :, None, :] * decay, kc)
        o = o_inter + jnp.einsum('bhts,bhsv->bhtv', a, vc)
        g_last = g[:, :, -1:, :]
        new_state = (jnp.exp(g_last[:, :, 0, :])[..., None] * state
                     + jnp.einsum('bhsk,bhsv->bhkv', kc * jnp.exp(g_last - g), vc))
        return new_state, o

    s_fin, o = lax.scan(step, s0, (to_chunks(q), to_chunks(k), to_chunks(v), to_chunks(logf)))
    o = jnp.moveaxis(o, 0, 2).reshape(b, h, t, dv)
    return o, s_fin


def gla_final_state(k, v, logf):
    g = jnp.cumsum(logf, axis=2)
    return jnp.einsum('bhsk,bhsv->bhkv', k * jnp.exp(g[:, :, -1:, :] - g), v)


def hgrn_bidir(q, kf, lff, kb, lfb, v, s_f, s_b):
    o_f, s_f_new = gla_chunked(q, kf, v, lff, s_f)
    o_b, s_b_new = gla_chunked(_flip_t(q), _flip_t(kb), _flip_t(v), _flip_t(lfb), s_b)
    return o_f + _flip_t(o_b), s_f_new, s_b_new


def hgrn_readout(o, g_raw, norm_g):
    o = rms_norm(jnp.swapaxes(o, 1, 2), norm_g)
    return o.reshape(g_raw.shape).astype(g_raw.dtype) * jax.nn.silu(g_raw)


def merge_branches(o_four, o_attn, o_hgrn, gate_raw, w_branch, w_out):
    br = jnp.stack([o_four, o_attn, o_hgrn], axis=-2)
    proj = jnp.einsum('btnc,ncd->btnd', br, w_branch)
    gates = jax.nn.sigmoid(gate_raw.reshape(gate_raw.shape[:-1] + (N_BRANCH, D_MODEL)))
    return jnp.sum(gates * proj, axis=-2) @ w_out


def sq_relu_mlp(h, w1, w2):
    return jnp.square(jax.nn.relu(h @ w1)) @ w2


def setup_inputs(seed: int = 0) -> dict:
    key = jax.random.key(seed)
    ks = jax.random.split(key, 18)

    def nrm(k, shape, s):
        return jax.random.normal(k, shape, F32) * s

    return {
        "x": nrm(ks[0], (BATCH, SEQ, D_MODEL), 1.0),
        "c": nrm(ks[1], (BATCH, D_MODEL), 1.0),
        "ctx": nrm(ks[2], (BATCH, CTX_LEN, D_MODEL), 1.0),
        "c_ctx": nrm(ks[3], (D_MODEL,), 1.0),
        "w_mod": nrm(ks[4], (DEPTH, D_MODEL, 6 * D_MODEL), 0.5 * D_MODEL ** -0.5),
        "b_mod": nrm(ks[5], (DEPTH, 6 * D_MODEL), 0.02),
        "norm1_g": 1.0 + nrm(ks[6], (DEPTH, D_MODEL), 0.02),
        "norm2_g": 1.0 + nrm(ks[7], (DEPTH, D_MODEL), 0.02),
        "w_in": nrm(ks[8], (DEPTH, D_MODEL, D_IN), D_MODEL ** -0.5),
        "q_norm_g": 1.0 + nrm(ks[9], (DEPTH, HEAD_DIM), 0.02),
        "k_norm_g": 1.0 + nrm(ks[10], (DEPTH, HEAD_DIM), 0.02),
        "attn_sink": nrm(ks[11], (DEPTH, ATTN_HEADS), 0.5),
        "hgrn_lb_logits": nrm(ks[12], (DEPTH, 2, HGRN_KW), 0.5),
        "hgrn_norm_g": 1.0 + nrm(ks[13], (DEPTH, HGRN_DV), 0.02),
        "w_branch": nrm(ks[14], (DEPTH, N_BRANCH, BRANCH_WIDTH, D_MODEL), BRANCH_WIDTH ** -0.5),
        "w_out": nrm(ks[15], (DEPTH, D_MODEL, D_MODEL), D_MODEL ** -0.5),
        "w_ff1": nrm(ks[16], (DEPTH, D_MODEL, D_FF), D_MODEL ** -0.5),
        "w_ff2": nrm(ks[17], (DEPTH, D_FF, D_MODEL), D_FF ** -0.5),
    }


def reference(x, c, ctx, c_ctx, w_mod, b_mod, norm1_g, norm2_g, w_in, q_norm_g, k_norm_g,
              attn_sink, hgrn_lb_logits, hgrn_norm_g, w_branch, w_out, w_ff1, w_ff2):
    bsz, n_tok, _ = x.shape
    rope = axial_rope_tables(n_tok)
    lb_p = jax.nn.softmax(hgrn_lb_logits.astype(F32), axis=0)
    lb_all = jnp.cumsum(lb_p, axis=0) - lb_p[0:1]
    xc = ctx
    for l in range(DEPTH):
        last = l == DEPTH - 1
        mx = [m[:, None, :] for m in modulation(c, w_mod[l], b_mod[l])]
        mc = modulation(c_ctx, w_mod[l], b_mod[l])
        h = adaln_norm(x, norm1_g[l], mx[0], mx[1])
        hc = adaln_norm(xc, norm1_g[l], mc[0], mc[1])

        if last:
            kc_raw, vc_raw, ic_raw, fcf_raw, fcb_raw = jnp.split(
                hc @ w_in[l][:, :N_STATE_COLS], STATE_SPLITS, axis=-1)
        else:
            (kc_raw, vc_raw, ic_raw, fcf_raw, fcb_raw, qc_raw, qhc_raw, ghc_raw,
             fourc_raw, gatec_raw) = jnp.split(hc @ w_in[l], IN_SPLITS, axis=-1)
        kc = rms_norm(_heads(kc_raw, ATTN_KV_HEADS), k_norm_g[l])
        vc = _heads(vc_raw, ATTN_KV_HEADS)
        vhc, kfc, lffc, kbc, lfbc = hgrn_kv(ic_raw, fcf_raw, fcb_raw, lb_all[l])
        if last:
            s_f = gla_final_state(kfc, vhc, lffc)
            s_b = gla_final_state(_flip_t(kbc), _flip_t(vhc), _flip_t(lfbc))
        else:
            zeros = jnp.zeros((bsz, HGRN_HEADS, HGRN_DK, HGRN_DV), F32)
            oc_h, s_f, s_b = hgrn_bidir(hgrn_q(qhc_raw), kfc, lffc, kbc, lfbc, vhc, zeros, zeros)
            qc = rms_norm(_heads(qc_raw, ATTN_HEADS), q_norm_g[l])
            oc_a = context_attention(qc, kc, vc, attn_sink[l])
            oc_f = fourier_mix(fourc_raw)
            oc_hr = hgrn_readout(oc_h, ghc_raw, hgrn_norm_g[l])
            yc = merge_branches(oc_f, oc_a, oc_hr, gatec_raw, w_branch[l], w_out[l])
            xc = xc + mc[2] * yc
            hc2 = adaln_norm(xc, norm2_g[l], mc[3], mc[4])
            xc = xc + mc[5] * sq_relu_mlp(hc2, w_ff1[l], w_ff2[l])

        (k_raw, v_raw, i_raw, ff_raw, fb_raw, q_raw, qh_raw, gh_raw,
         four_raw, gate_raw) = jnp.split(h @ w_in[l], IN_SPLITS, axis=-1)
        q = apply_axial_rope(rms_norm(_heads(q_raw, ATTN_HEADS), q_norm_g[l]), rope)
        k = apply_axial_rope(rms_norm(_heads(k_raw, ATTN_KV_HEADS), k_norm_g[l]), rope)
        v = _heads(v_raw, ATTN_KV_HEADS)
        o_a = window_attention(q, k, v, kc, vc, attn_sink[l])
        vh, kf, lff, kb, lfb = hgrn_kv(i_raw, ff_raw, fb_raw, lb_all[l])
        o_h, _, _ = hgrn_bidir(hgrn_q(qh_raw), kf, lff, kb, lfb, vh, s_f, s_b)
        o_hr = hgrn_readout(o_h, gh_raw, hgrn_norm_g[l])
        o_f = fourier_mix(four_raw)
        y = merge_branches(o_f, o_a, o_hr, gate_raw, w_branch[l], w_out[l])
        x = x + mx[2] * y
        h2 = adaln_norm(x, norm2_g[l], mx[3], mx[4])
        x = x + mx[5] * sq_relu_mlp(h2, w_ff1[l], w_ff2[l])
    return x
```

```cpp
#include <hip/hip_runtime.h>
#include <hip/hip_cooperative_groups.h>
#include <cstdio>
#include <cstdint>
namespace cg = cooperative_groups;

#define LAS __attribute__((address_space(3)))
typedef unsigned short bf16_t;
typedef short bf16x8 __attribute__((ext_vector_type(8)));
typedef float f32x4 __attribute__((ext_vector_type(4)));
typedef unsigned u32x4 __attribute__((ext_vector_type(4)));
typedef unsigned u32x2 __attribute__((ext_vector_type(2)));

constexpr int NB = 8, T = 2048, TC = 256, D = 1024, DFF = 4096, DEPTH = 4;
constexpr int ML = NB * T, MC = NB * TC, M = ML + MC;
constexpr int DIN = 6912, ZLD = 6400;
constexpr int ZK = 0, ZV = 128, ZI = 256, ZFF = 768, ZFB = 1280, ZQ = 1792, ZQH = 2304, ZGH = 2816, ZG = 3328;
constexpr float EPS = 1e-6f;
constexpr int NT = 512;

constexpr size_t WS_W1T = 0;
constexpr size_t WS_W2T = WS_W1T + (size_t)ZLD * D * 2;
constexpr size_t WS_WBT = WS_W2T + (size_t)1024 * D * 2;
constexpr size_t WS_WOT = WS_WBT + (size_t)3072 * 512 * 2;
constexpr size_t WS_WF1T = WS_WOT + (size_t)D * D * 2;
constexpr size_t WS_WF2T = WS_WF1T + (size_t)DFF * D * 2;
constexpr size_t WS_FT = WS_WF2T + (size_t)D * DFF * 2;
constexpr size_t WS_FC = WS_FT + (size_t)T * 2 * T * 2;
constexpr size_t WS_MOD = WS_FC + (size_t)TC * 2 * TC * 2;
constexpr size_t WS_ROPE = WS_MOD + (size_t)DEPTH * 9 * 6144 * 4;
constexpr size_t WS_XC = WS_ROPE + 16384;
constexpr size_t WS_H = WS_XC + (size_t)MC * D * 4;
constexpr size_t WS_PQ = WS_H + (size_t)M * D * 2;
constexpr size_t WS_SS = WS_PQ + (size_t)M * D * 2;
constexpr size_t WS_Z1 = WS_SS + (size_t)M * D * 4;
constexpr size_t WS_END = WS_Z1 + (size_t)M * ZLD * 2;
constexpr size_t PQ_CTX_OFF = (size_t)NB * 512 * 4096 * 2;

constexpr int LDS_BYTES = 147456;
#ifndef PH_MASK
#define PH_MASK 0xFFFF
#endif
#define PH(b) if constexpr ((PH_MASK >> (b)) & 1)

struct Args { const float* in[18]; float* out; unsigned char* ws; };
typedef const __attribute__((address_space(4))) Args* ArgsP;

__device__ __forceinline__ unsigned cvt_pk_bf16(float lo, float hi) { unsigned r; asm volatile("v_cvt_pk_bf16_f32 %0, %1, %2" : "=v"(r) : "v"(lo), "v"(hi)); return r; }
__device__ __forceinline__ bf16_t f2bf(float f) { return (bf16_t)(cvt_pk_bf16(f, 0.f) & 0xffffu); }
__device__ __forceinline__ float bflo(unsigned u) { return __uint_as_float(u << 16); }
__device__ __forceinline__ float bfhi(unsigned u) { return __uint_as_float(u & 0xffff0000u); }
__device__ __forceinline__ float bf2f(bf16_t h) { return __uint_as_float((unsigned)h << 16); }
__device__ __forceinline__ float wave_sum(float v) {
#pragma unroll
    for (int o = 1; o < 64; o <<= 1) v += __shfl_xor(v, o);
    return v;
}
__device__ __forceinline__ int tid_() { int t = threadIdx.x; asm volatile("" : "+v"(t)); return t; }
__device__ __forceinline__ float sigmoidf_(float z) { return 1.0f / (1.0f + __expf(-z)); }

namespace pg8 {
constexpr int BM = 256, BK = 64, HALF = 128, HTB = HALF * BK * 2, NXCD = 8, WGM = 8;
__device__ __forceinline__ int lds_byte(int r, int c) { const int st = (r >> 4) * 2 + (c >> 5), rr = r & 15, cc = c & 31, ob = rr * 64 + cc * 2; return st * 1024 + (ob ^ (((ob >> 9) & 1) << 5)); }
__device__ __forceinline__ void stage_rc(int b, int& R, int& C) { const int st = b / 1024, sb = b % 1024, swz = sb ^ (((sb >> 9) & 1) << 5); R = (st >> 1) * 16 + swz / 64; C = (st & 1) * 32 + (swz % 64) / 2; }
__device__ __forceinline__ int perm32(int rho) { const int n = rho >> 4, i = rho & 15; return 8 * (i >> 2) + 4 * n + (i & 3); }

struct Unit { const char* A; const char* B; int lda; int pm, pn, aux; };

__device__ __forceinline__ void map_tile(int L, int nM, int nN, int& pm, int& pn) {
    const int nwg = nM * nN; int wgid = L;
    { const int q = nwg / NXCD, r = nwg % NXCD, xcd = wgid % NXCD, off = wgid / NXCD; wgid = (xcd < r ? xcd * (q + 1) : r * (q + 1) + (xcd - r) * q) + off; }
    const int nig = WGM * nN, gid = wgid / nig, fm = gid * WGM, gsz = (nM - fm) < WGM ? (nM - fm) : WGM;
    pm = fm + ((wgid % nig) % gsz); pn = (wgid % nig) / gsz;
}

template <class Epi, class Sched, bool VARLDA>
__device__ __forceinline__ void gemm_phase(LAS unsigned char* lds, const int K, const Sched& S, const Epi& E) {
    const int tid = tid_(), wid = __builtin_amdgcn_readfirstlane(tid >> 6), lane = tid & 63, wr = wid >> 2, wc = wid & 3, fr = lane & 15, fq = lane >> 4;
    const int nt = K / BK;
    Unit cur, nxt; int ui = 0;
    if (!S.next(0, cur)) return;
    unsigned voffA[2], voffB[2];
#pragma unroll
    for (int i = 0; i < 2; ++i) { int R, C; stage_rc(tid * 16 + i * 8192, R, C); const int Rb = Epi::PERM ? ((R & ~31) + perm32(R & 31)) : R;
        voffA[i] = (unsigned)(R * cur.lda + C) * 2u; voffB[i] = (unsigned)(Rb * K + C) * 2u; }
    const size_t kstep = (size_t)(BK * 2);
    size_t hstepA = (size_t)HALF * cur.lda * 2;
    const size_t hstepB = (size_t)HALF * K * 2;
    const unsigned ldsw = (unsigned)wid * 1024u;
    const int aoff = lds_byte(wr * 64 + fr, fq * 8), boff = lds_byte(wc * 32 + fr, fq * 8);
#define PG8_SA(b, h) (((b) * 2 + (h)) * HTB)
#define PG8_SB(b, h) ((4 + (b) * 2 + (h)) * HTB)
#define PG8_STAGE(bufoff, gbase, voff) do { _Pragma("unroll") for (int _i = 0; _i < 2; ++_i) \
        __builtin_amdgcn_global_load_lds((const unsigned*)((const char*)(gbase) + (voff)[_i]), (LAS unsigned*)(lds + (bufoff) + ldsw + _i * 8192), 16, 0, 0); } while (0)
#define PG8_LDA(dst, b, h) do { _Pragma("unroll") for (int m = 0; m < 4; ++m) _Pragma("unroll") for (int k = 0; k < 2; ++k) dst[m][k] = *(const LAS bf16x8*)(lds + PG8_SA(b, h) + aoff + m * 2048 + k * 1024); } while (0)
#define PG8_LDB(dst, b, h) do { _Pragma("unroll") for (int n = 0; n < 2; ++n) _Pragma("unroll") for (int k = 0; k < 2; ++k) dst[n][k] = *(const LAS bf16x8*)(lds + PG8_SB(b, h) + boff + n * 2048 + k * 1024); } while (0)
#define PG8_MMA(ai, bj, At, Bt) do { __builtin_amdgcn_s_setprio(1); _Pragma("unroll") for (int m = 0; m < 4; ++m) _Pragma("unroll") for (int n = 0; n < 2; ++n) _Pragma("unroll") for (int k = 0; k < 2; ++k) \
        acc[ai][bj][m][n] = __builtin_amdgcn_mfma_f32_16x16x32_bf16(Bt[n][k], At[m][k], acc[ai][bj][m][n], 0, 0, 0); __builtin_amdgcn_s_setprio(0); } while (0)
#define PG8_WAIT_V(n) asm volatile("s_waitcnt vmcnt(" #n ")" ::: "memory")
#define PG8_WAIT_L(n) asm volatile("s_waitcnt lgkmcnt(" #n ")" ::: "memory")
#define PG8_BAR __builtin_amdgcn_s_barrier()
#define PG8_SCHED __builtin_amdgcn_sched_barrier(0)
    f32x4 acc[2][2][4][2];
#pragma unroll
    for (int a = 0; a < 2; ++a)
#pragma unroll
        for (int b = 0; b < 2; ++b)
#pragma unroll
            for (int m = 0; m < 4; ++m)
#pragma unroll
                for (int n = 0; n < 2; ++n) acc[a][b][m][n] = (f32x4){0.f, 0.f, 0.f, 0.f};
    bf16x8 At[4][2], B0[2][2], B1[2][2];
    const char* cA = cur.A; const char* cB = cur.B;
    PG8_STAGE(PG8_SB(0, 0), cB, voffB); PG8_STAGE(PG8_SB(0, 1), cB + hstepB, voffB); PG8_STAGE(PG8_SA(0, 0), cA, voffA); PG8_STAGE(PG8_SA(0, 1), cA + hstepA, voffA);
    if (wr == 1) PG8_BAR;
    PG8_WAIT_V(2); PG8_BAR;
    PG8_STAGE(PG8_SB(1, 0), cB + kstep, voffB); PG8_STAGE(PG8_SA(1, 0), cA + kstep, voffA); PG8_STAGE(PG8_SB(1, 1), cB + hstepB + kstep, voffB);
    PG8_WAIT_V(6); PG8_BAR;
    for (;;) {
        const bool has_next = S.next(ui + 1, nxt);
        const char* nA = has_next ? nxt.A : cA; const char* nB = has_next ? nxt.B : cB;
        for (int t = 0; t < nt; t += 2) {
            const bool last = (t == nt - 2);
            const char* a1 = cA + (size_t)(t + 1) * kstep;
            const char* a2 = last ? nA : cA + (size_t)(t + 2) * kstep; const char* b2 = last ? nB : cB + (size_t)(t + 2) * kstep;
            const char* a3 = a2 + kstep; const char* b3 = b2 + kstep;
            PG8_LDB(B0, 0, 0); PG8_LDB(B1, 0, 1); PG8_SCHED; PG8_LDA(At, 0, 0); PG8_STAGE(PG8_SA(1, 1), a1 + hstepA, voffA);
            if constexpr (VARLDA) { if (last && has_next) {
#pragma unroll
                for (int i = 0; i < 2; ++i) { int R, C; stage_rc(tid * 16 + i * 8192, R, C); voffA[i] = (unsigned)(R * nxt.lda + C) * 2u; }
                hstepA = (size_t)HALF * nxt.lda * 2; } }
            PG8_WAIT_V(8); PG8_WAIT_L(0); PG8_BAR; PG8_MMA(0, 0, At, B0); PG8_MMA(0, 1, At, B1); PG8_BAR; PG8_SCHED;
            PG8_LDA(At, 0, 1); PG8_STAGE(PG8_SB(0, 0), b2, voffB); PG8_STAGE(PG8_SB(0, 1), b2 + hstepB, voffB); PG8_STAGE(PG8_SA(0, 0), a2, voffA);
            PG8_WAIT_V(8); PG8_WAIT_L(0); PG8_BAR; PG8_MMA(1, 0, At, B0); PG8_MMA(1, 1, At, B1); PG8_BAR; PG8_SCHED;
            PG8_LDB(B0, 1, 0); PG8_LDB(B1, 1, 1); PG8_SCHED; PG8_LDA(At, 1, 0); PG8_STAGE(PG8_SA(0, 1), a2 + hstepA, voffA);
            PG8_WAIT_V(8); PG8_WAIT_L(0); PG8_BAR; PG8_MMA(0, 0, At, B0); PG8_MMA(0, 1, At, B1); PG8_BAR; PG8_SCHED;
            PG8_LDA(At, 1, 1); PG8_STAGE(PG8_SB(1, 0), b3, voffB); PG8_STAGE(PG8_SB(1, 1), b3 + hstepB, voffB); PG8_STAGE(PG8_SA(1, 0), a3, voffA);
            PG8_WAIT_V(8); PG8_WAIT_L(0); PG8_BAR; PG8_MMA(1, 0, At, B0); PG8_MMA(1, 1, At, B1); PG8_BAR; PG8_SCHED;
        }
        if (wr == 0) PG8_BAR;
        E(acc, cur, wr, wc, fr, fq);
        if (!has_next) break;
#pragma unroll
        for (int a = 0; a < 2; ++a)
#pragma unroll
            for (int b = 0; b < 2; ++b)
#pragma unroll
                for (int m = 0; m < 4; ++m)
#pragma unroll
                    for (int n = 0; n < 2; ++n) acc[a][b][m][n] = (f32x4){0.f, 0.f, 0.f, 0.f};
        cur = nxt; cA = nA; cB = nB; ++ui;
        if (wr == 1) PG8_BAR;
    }
    PG8_WAIT_V(0);
    PG8_BAR;
#undef PG8_SA
#undef PG8_SB
#undef PG8_STAGE
#undef PG8_LDA
#undef PG8_LDB
#undef PG8_MMA
#undef PG8_WAIT_V
#undef PG8_WAIT_L
#undef PG8_BAR
#undef PG8_SCHED
}
}
using pg8::Unit;

struct SchedPlain {
    const char* A; const char* B; int lda, K, nM, nN, G, c;
    __device__ __forceinline__ bool next(int i, Unit& u) const {
        const long L = (long)i * G + c; if (L >= (long)nM * nN) return false;
        pg8::map_tile((int)L, nM, nN, u.pm, u.pn); u.aux = 0; u.lda = lda;
        u.A = A + (size_t)u.pm * 256 * lda * 2; u.B = B + (size_t)u.pn * 256 * K * 2; return true;
    }
};
struct SchedInproj {
    const char* H; const char* W1t; const char* W2t; int G, c;
    __device__ __forceinline__ bool next(int i, Unit& u) const {
        const int L = i * G + c; u.lda = D;
        if (L < 72 * 25) { pg8::map_tile(L, 72, 25, u.pm, u.pn); u.aux = 0; u.A = H + (size_t)u.pm * 256 * D * 2; u.B = W1t + (size_t)u.pn * 256 * D * 2; return true; }
        const int L2 = L - 72 * 25; if (L2 >= 4 * 72) return false;
        pg8::map_tile(L2, 4, 72, u.pm, u.pn); u.aux = 1; u.A = W2t + (size_t)u.pm * 256 * D * 2; u.B = H + (size_t)u.pn * 256 * D * 2; return true;
    }
};
struct SchedBranch {
    const char* YF; const char* Z1; const char* Wbt; int G, c;
    __device__ __forceinline__ bool next(int i, Unit& u) const {
        const int L = (i / 3) * G + c, n = i % 3; if (L >= 72 * 4) return false;
        pg8::map_tile(L, 72, 4, u.pm, u.pn); u.aux = n;
        if (n == 0) { u.lda = 512; u.A = YF + (size_t)u.pm * 256 * 512 * 2; }
        else { u.lda = ZLD; u.A = Z1 + ((size_t)u.pm * 256 * ZLD + (n == 1 ? ZQ : ZGH)) * 2; }
        u.B = Wbt + ((size_t)n * 1024 + (size_t)u.pn * 256) * 512 * 2; return true;
    }
};

struct SchedCtx { const char* A; const char* B; int G, c;
    __device__ __forceinline__ bool next(int i, Unit& u) const { const int L = i * G + c; if (L >= 16) return false; u.pm = 0; u.pn = L; u.aux = 1; u.lda = 512; u.A = A; u.B = B + (size_t)L * 256 * 512 * 2; return true; } };

struct EpiInproj {
    static constexpr bool PERM = true;
    bf16_t* Z1; bf16_t* PQ;
    __device__ __forceinline__ void operator()(const f32x4 (&acc)[2][2][4][2], const Unit& u, int wr, int wc, int fr, int fq) const {
#pragma unroll
        for (int ai = 0; ai < 2; ++ai)
#pragma unroll
            for (int m = 0; m < 4; ++m) {
                const int row = u.pm * 256 + ai * 128 + wr * 64 + m * 16 + fr;
#pragma unroll
                for (int bj = 0; bj < 2; ++bj) {
                    const int colt = bj * 128 + wc * 32 + 8 * fq;
                    const f32x4 v0 = acc[ai][bj][m][0], v1 = acc[ai][bj][m][1];
                    u32x4 w; w.x = cvt_pk_bf16(v0[0], v0[1]); w.y = cvt_pk_bf16(v0[2], v0[3]); w.z = cvt_pk_bf16(v1[0], v1[1]); w.w = cvt_pk_bf16(v1[2], v1[3]);
                    bf16_t* dst;
                    if (u.aux == 0) dst = Z1 + (size_t)row * ZLD + u.pn * 256 + colt;
                    else {
                        const int ch = row & 511, part = row >> 9;
                        if (u.pn < 64) { const int b = u.pn >> 3, t0 = (u.pn & 7) * 256 + colt; dst = PQ + ((size_t)(b * 512 + ch) * 4096 + part * 2048 + t0); }
                        else { const int b = u.pn - 64; dst = PQ + PQ_CTX_OFF / 2 + ((size_t)(b * 512 + ch) * 512 + part * 256 + colt); }
                    }
                    *(u32x4*)dst = w;
                }
            }
    }
};
struct EpiFourier {
    static constexpr bool PERM = true;
    bf16_t* YF;
    __device__ __forceinline__ void operator()(const f32x4 (&acc)[2][2][4][2], const Unit& u, int wr, int wc, int fr, int fq) const {
        const int b = u.pn >> 1; const int rowbase = u.aux ? (ML + b * 256) : (b * 2048);
#pragma unroll
        for (int ai = 0; ai < 2; ++ai)
#pragma unroll
            for (int m = 0; m < 4; ++m) {
                const int tp = u.pm * 256 + ai * 128 + wr * 64 + m * 16 + fr;
#pragma unroll
                for (int bj = 0; bj < 2; ++bj) {
                    const int ch = (u.pn & 1) * 256 + bj * 128 + wc * 32 + 8 * fq;
                    const f32x4 v0 = acc[ai][bj][m][0], v1 = acc[ai][bj][m][1];
                    u32x4 w; w.x = cvt_pk_bf16(v0[0], v0[1]); w.y = cvt_pk_bf16(v0[2], v0[3]); w.z = cvt_pk_bf16(v1[0], v1[1]); w.w = cvt_pk_bf16(v1[2], v1[3]);
                    *(u32x4*)(YF + (size_t)(rowbase + tp) * 512 + ch) = w;
                }
            }
    }
};
struct EpiRelu2 {
    static constexpr bool PERM = true;
    bf16_t* HF;
    __device__ __forceinline__ void operator()(const f32x4 (&acc)[2][2][4][2], const Unit& u, int wr, int wc, int fr, int fq) const {
#pragma unroll
        for (int ai = 0; ai < 2; ++ai)
#pragma unroll
            for (int m = 0; m < 4; ++m) {
                const int row = u.pm * 256 + ai * 128 + wr * 64 + m * 16 + fr;
#pragma unroll
                for (int bj = 0; bj < 2; ++bj) {
                    const int col = u.pn * 256 + bj * 128 + wc * 32 + 8 * fq;
                    f32x4 v0 = acc[ai][bj][m][0], v1 = acc[ai][bj][m][1];
#pragma unroll
                    for (int j = 0; j < 4; ++j) { const float a = fmaxf(v0[j], 0.f), b = fmaxf(v1[j], 0.f); v0[j] = a * a; v1[j] = b * b; }
                    u32x4 w; w.x = cvt_pk_bf16(v0[0], v0[1]); w.y = cvt_pk_bf16(v0[2], v0[3]); w.z = cvt_pk_bf16(v1[0], v1[1]); w.w = cvt_pk_bf16(v1[2], v1[3]);
                    *(u32x4*)(HF + (size_t)row * DFF + col) = w;
                }
            }
    }
};
struct EpiBranch {
    static constexpr bool PERM = false;
    const bf16_t* Z1; float* U; bf16_t* Ub;
    __device__ __forceinline__ void operator()(const f32x4 (&acc)[2][2][4][2], const Unit& u, int wr, int wc, int fr, int fq) const {
        const int n_ = u.aux;
#pragma unroll
        for (int ai = 0; ai < 2; ++ai)
#pragma unroll
            for (int m = 0; m < 4; ++m) {
                const int row = u.pm * 256 + ai * 128 + wr * 64 + m * 16 + fr;
#pragma unroll
                for (int bj = 0; bj < 2; ++bj)
#pragma unroll
                    for (int n = 0; n < 2; ++n) {
                        const int col = u.pn * 256 + bj * 128 + wc * 32 + 16 * n + 4 * fq;
                        const u32x2 gr = *(const u32x2*)(Z1 + (size_t)row * ZLD + ZG + n_ * 1024 + col);
                        const f32x4 a = acc[ai][bj][m][n];
                        f32x4 v; v[0] = sigmoidf_(bflo(gr.x)) * a[0]; v[1] = sigmoidf_(bfhi(gr.x)) * a[1]; v[2] = sigmoidf_(bflo(gr.y)) * a[2]; v[3] = sigmoidf_(bfhi(gr.y)) * a[3];
                        float* up = U + (size_t)row * D + col;
                        if (n_ == 0) *(f32x4*)up = v;
                        else { const f32x4 o = *(const f32x4*)up; v = v + o;
                            if (n_ == 1) *(f32x4*)up = v;
                            else { u32x2 w; w.x = cvt_pk_bf16(v[0], v[1]); w.y = cvt_pk_bf16(v[2], v[3]); *(u32x2*)(Ub + (size_t)row * D + col) = w; } }
                    }
            }
    }
};
struct EpiResid {
    static constexpr bool PERM = false;
    float* out; float* XC; const float* modl; int gsel;
    __device__ __forceinline__ void operator()(const f32x4 (&acc)[2][2][4][2], const Unit& u, int wr, int wc, int fr, int fq) const {
        const int row0 = u.pm * 256; const int bidx = row0 < ML ? (row0 >> 11) : 8;
        float* xb = (row0 < ML ? out + (size_t)row0 * D : XC + (size_t)(row0 - ML) * D) + (size_t)(wr * 64 + fr) * D + u.pn * 256 + wc * 32 + 4 * fq;
        const float* gp = modl + (size_t)bidx * 6144 + gsel * 1024 + u.pn * 256 + wc * 32 + 4 * fq;
#pragma unroll
        for (int bj = 0; bj < 2; ++bj)
#pragma unroll
            for (int n = 0; n < 2; ++n) {
                const f32x4 g = *(const f32x4*)(gp + bj * 128 + 16 * n);
#pragma unroll
                for (int ai = 0; ai < 2; ++ai)
#pragma unroll
                    for (int m = 0; m < 4; ++m) {
                        float* xp = xb + (size_t)(ai * 128 + m * 16) * D + bj * 128 + 16 * n;
                        f32x4 o = *(const f32x4*)xp; o = o + g * acc[ai][bj][m][n]; *(f32x4*)xp = o;
                    }
            }
    }
};

__device__ __forceinline__ void transpose_item(const float* W, int ldw, int K, int ncols, bf16_t* WT, LAS float* scr, int item, int lane) {
    const int nblk = ncols / 32, kb = item / nblk, nb = item % nblk, k0 = 64 * kb, n0 = 32 * nb;
#pragma unroll 8
    for (int i = 0; i < 32; ++i) { const int kk = 2 * i + (lane >> 5); scr[kk * 33 + (lane & 31)] = W[(size_t)(k0 + kk) * ldw + n0 + (lane & 31)]; }
    asm volatile("s_waitcnt lgkmcnt(0)" ::: "memory");
    const int c = lane & 7;
#pragma unroll
    for (int j = 0; j < 4; ++j) { const int n = (lane >> 3) + 8 * j; const LAS float* s = scr + (8 * c) * 33 + n;
        u32x4 o; o.x = cvt_pk_bf16(s[0 * 33], s[1 * 33]); o.y = cvt_pk_bf16(s[2 * 33], s[3 * 33]); o.z = cvt_pk_bf16(s[4 * 33], s[5 * 33]); o.w = cvt_pk_bf16(s[6 * 33], s[7 * 33]);
        *(u32x4*)(WT + (size_t)(n0 + n) * K + k0 + 8 * c) = o; }
    asm volatile("s_waitcnt lgkmcnt(0)" ::: "memory");
}

__device__ __forceinline__ void convert_weights(ArgsP a, int l, LAS unsigned char* lds) {
    unsigned char* ws = a->ws;
    const int tid = tid_(), lane = tid & 63, wave = tid >> 6, G = gridDim.x;
    const float* w_in = a->in[8] + (size_t)l * D * DIN;
    {
        LAS float* wt = (LAS float*)lds;
        LAS float* cs = wt + 64 * 129; LAS float* sn = cs + 128;
        bf16_t* W2t = (bf16_t*)(ws + WS_W2T);
        for (int it = blockIdx.x; it < 64; it += G) {
            const int g = it >> 4, kb = it & 15;
            for (int i = tid; i < 64 * 128; i += NT) { const int kk = i >> 7, c = i & 127; wt[kk * 129 + c] = w_in[(size_t)(kb * 64 + kk) * DIN + 3328 + g * 128 + c]; }
            if (tid < 128) { cs[tid] = cospif((float)tid / 64.0f); sn[tid] = sinpif((float)tid / 64.0f); }
            __syncthreads();
            const int kk = tid & 63, cg8 = tid >> 6;
            for (int ci = 0; ci < 16; ++ci) {
                const int cp = cg8 * 16 + ci; float ap = 0.f, aq = 0.f;
#pragma unroll 8
                for (int c = 0; c < 128; ++c) { const int mm = (c * cp) & 127; const float wv = wt[kk * 129 + c]; ap += wv * cs[mm]; aq += wv * sn[mm]; }
                const float s128 = 0.08838834764831845f;
                W2t[(size_t)(g * 128 + cp) * D + kb * 64 + kk] = f2bf(ap * s128);
                W2t[(size_t)(512 + g * 128 + cp) * D + kb * 64 + kk] = f2bf(aq * s128);
            }
            __syncthreads();
        }
    }
    {
        LAS float* scr = (LAS float*)(lds + 40960 + wave * 8704);
        const int gw = blockIdx.x * 8 + wave, NGW = G * 8;
        bf16_t* W1t = (bf16_t*)(ws + WS_W1T); bf16_t* Wbt = (bf16_t*)(ws + WS_WBT); bf16_t* Wot = (bf16_t*)(ws + WS_WOT);
        bf16_t* Wf1t = (bf16_t*)(ws + WS_WF1T); bf16_t* Wf2t = (bf16_t*)(ws + WS_WF2T);
        const float* w_br = a->in[14] + (size_t)l * 3 * 512 * D; const float* w_out = a->in[15] + (size_t)l * D * D;
        const float* w_f1 = a->in[16] + (size_t)l * D * DFF; const float* w_f2 = a->in[17] + (size_t)l * DFF * D;
        constexpr int I_A = 16 * 104, I_B = 16 * 96, I_C = 8 * 32, I_D = 16 * 32, I_E = 16 * 128, I_F = 64 * 32;
        constexpr int NIT = I_A + I_B + 3 * I_C + I_D + I_E + I_F;
        for (int it = gw; it < NIT; it += NGW) {
            int r = it;
            if (r < I_A) { transpose_item(w_in, DIN, D, 3328, W1t, scr, r, lane); continue; } r -= I_A;
            if (r < I_B) { transpose_item(w_in + 3840, DIN, D, 3072, W1t + (size_t)3328 * D, scr, r, lane); continue; } r -= I_B;
            if (r < 3 * I_C) { const int n = r / I_C; transpose_item(w_br + (size_t)n * 512 * D, D, 512, D, Wbt + (size_t)n * 1024 * 512, scr, r % I_C, lane); continue; } r -= 3 * I_C;
            if (r < I_D) { transpose_item(w_out, D, D, D, Wot, scr, r, lane); continue; } r -= I_D;
            if (r < I_E) { transpose_item(w_f1, DFF, D, DFF, Wf1t, scr, r, lane); continue; } r -= I_E;
            transpose_item(w_f2, D, DFF, D, Wf2t, scr, r, lane);
        }
    }
    __syncthreads();
}

__device__ __forceinline__ void prologue(ArgsP a, LAS unsigned char* lds) {
    unsigned char* ws = a->ws;
    const int tid = tid_(), G = gridDim.x;
    const int gtid = blockIdx.x * NT + tid, gsz = G * NT;
    { const f32x4* xs = (const f32x4*)a->in[0]; f32x4* xo = (f32x4*)a->out; for (int i = gtid; i < ML * D / 4; i += gsz) xo[i] = xs[i];
      const f32x4* cs_ = (const f32x4*)a->in[2]; f32x4* co = (f32x4*)(ws + WS_XC); for (int i = gtid; i < MC * D / 4; i += gsz) co[i] = cs_[i]; }
    { unsigned* FT = (unsigned*)(ws + WS_FT); const float sT = 0.022097086912079608f;
      for (int i = gtid; i < T * 2 * T / 2; i += gsz) { const int tp = i >> 11, j = (i & 2047) * 2; float v[2];
#pragma unroll
          for (int e = 0; e < 2; ++e) { const int jj = (j + e) & 2047; const int mm = (tp * jj) & 2047; const float ang = (float)mm / 1024.0f; v[e] = ((j + e) < 2048 ? cospif(ang) : -sinpif(ang)) * sT; }
          FT[i] = cvt_pk_bf16(v[0], v[1]); }
      unsigned* FC = (unsigned*)(ws + WS_FC); const float sC = 0.0625f;
      for (int i = gtid; i < TC * 2 * TC / 2; i += gsz) { const int tp = i >> 8, j = (i & 255) * 2; float v[2];
#pragma unroll
          for (int e = 0; e < 2; ++e) { const int jj = (j + e) & 255; const int mm = (tp * jj) & 255; const float ang = (float)mm / 128.0f; v[e] = ((j + e) < 256 ? cospif(ang) : -sinpif(ang)) * sC; }
          FC[i] = cvt_pk_bf16(v[0], v[1]); } }
    { float* RP = (float*)(ws + WS_ROPE);
      for (int i = gtid; i < 96 * 16; i += gsz) { const int pos = i >> 4, fi = i & 15; const float invf = exp2f(-(float)(2 * fi) / 32.0f * 13.287712379549449f);
          const float ang = (float)(pos < 32 ? pos : pos - 32) * invf; RP[2 * i] = __cosf(ang); RP[2 * i + 1] = __sinf(ang); } }
    {
        LAS float* sil = (LAS float*)lds; LAS float* red = sil + 9 * 1024;
        const float* c = a->in[1]; const float* cc = a->in[3]; const float* w_mod = a->in[4]; const float* b_mod = a->in[5];
        float* MOD = (float*)(ws + WS_MOD);
        for (int i = tid; i < 9 * 1024; i += NT) { const int j = i >> 10, k = i & 1023; const float cv = j < 8 ? c[j * 1024 + k] : cc[k]; sil[i] = cv / (1.0f + __expf(-cv)); }
        __syncthreads();
        for (int it = blockIdx.x; it < DEPTH * 48; it += G) {
            const int l = it / 48, n0 = (it % 48) * 128, col = tid & 127, kq = tid >> 7;
            float acc[9];
#pragma unroll
            for (int j = 0; j < 9; ++j) acc[j] = 0.f;
            const float* w = w_mod + (size_t)l * D * 6144 + n0 + col;
#pragma unroll 4
            for (int k = kq * 256; k < kq * 256 + 256; ++k) { const float wv = w[(size_t)k * 6144];
#pragma unroll
                for (int j = 0; j < 9; ++j) acc[j] += sil[j * 1024 + k] * wv; }
#pragma unroll
            for (int j = 0; j < 9; ++j) red[(kq * 9 + j) * 128 + col] = acc[j];
            __syncthreads();
            for (int o = tid; o < 9 * 128; o += NT) { const int j = o >> 7, c2 = o & 127;
                const float v = red[(0 * 9 + j) * 128 + c2] + red[(1 * 9 + j) * 128 + c2] + red[(2 * 9 + j) * 128 + c2] + red[(3 * 9 + j) * 128 + c2] + b_mod[l * 6144 + n0 + c2];
                MOD[(size_t)(l * 9 + j) * 6144 + n0 + c2] = v; }
            __syncthreads();
        }
    }
    convert_weights(a, 0, lds);
}

__device__ __forceinline__ void norm_phase(ArgsP a, int l, int sel) {
    unsigned char* ws = a->ws;
    const int lane = tid_() & 63, gw = blockIdx.x * 8 + (tid_() >> 6), NGW = gridDim.x * 8;
    const float* gn = a->in[sel ? 7 : 6] + l * D; const float* MOD = (const float*)(ws + WS_MOD);
    bf16_t* H = (bf16_t*)(ws + WS_H);
    for (int row = gw; row < M; row += NGW) {
        const float* src = row < ML ? a->out + (size_t)row * D : (const float*)(ws + WS_XC) + (size_t)(row - ML) * D;
        const int bidx = row < ML ? (row >> 11) : 8;
        const float* sh = MOD + (size_t)(l * 9 + bidx) * 6144 + (sel * 3) * 1024; const float* sc = sh + 1024;
        f32x4 v[4]; float ss = 0.f;
#pragma unroll
        for (int j = 0; j < 4; ++j) { v[j] = ((const f32x4*)src)[lane + 64 * j]; ss += (v[j][0] * v[j][0] + v[j][1] * v[j][1]) + (v[j][2] * v[j][2] + v[j][3] * v[j][3]); }
        ss = wave_sum(ss);
        const float rstd = rsqrtf(ss * (1.0f / D) + EPS);
#pragma unroll
        for (int j = 0; j < 4; ++j) { const int col = 4 * (lane + 64 * j);
            const f32x4 g = *(const f32x4*)(gn + col), s1 = *(const f32x4*)(sc + col), s0 = *(const f32x4*)(sh + col);
            f32x4 y;
#pragma unroll
            for (int e = 0; e < 4; ++e) y[e] = v[j][e] * rstd * g[e] * (1.0f + s1[e]) + s0[e];
            u32x2 w; w.x = cvt_pk_bf16(y[0], y[1]); w.y = cvt_pk_bf16(y[2], y[3]);
            *(u32x2*)(H + (size_t)row * D + col) = w; }
    }
}

__device__ __forceinline__ void qkprep_phase(ArgsP a, int l) {
    unsigned char* ws = a->ws;
    bf16_t* Z1 = (bf16_t*)(ws + WS_Z1); const float* RP = (const float*)(ws + WS_ROPE);
    const int gtid = blockIdx.x * NT + tid_(), gsz = gridDim.x * NT;
    for (int idx = gtid; idx < M * 40; idx += gsz) {
        const int p = idx & 3, hs = (idx >> 2) % 10, row = idx / 40;
        const int col = hs < 2 ? ZK + hs * 64 : ZQ + (hs - 2) * 64;
        const float* gn = (hs < 2 ? a->in[10] : a->in[9]) + l * 64;
        const int d0 = (p >> 1) * 32 + (p & 1) * 8;
        bf16_t* ptr = Z1 + (size_t)row * ZLD + col + d0;
        const u32x4 ra = *(const u32x4*)ptr, rb = *(const u32x4*)(ptr + 16);
        float u1[8], u2[8];
        u1[0] = bflo(ra.x); u1[1] = bfhi(ra.x); u1[2] = bflo(ra.y); u1[3] = bfhi(ra.y); u1[4] = bflo(ra.z); u1[5] = bfhi(ra.z); u1[6] = bflo(ra.w); u1[7] = bfhi(ra.w);
        u2[0] = bflo(rb.x); u2[1] = bfhi(rb.x); u2[2] = bflo(rb.y); u2[3] = bfhi(rb.y); u2[4] = bflo(rb.z); u2[5] = bfhi(rb.z); u2[6] = bflo(rb.w); u2[7] = bfhi(rb.w);
        float ss = 0.f;
#pragma unroll
        for (int i = 0; i < 8; ++i) ss += u1[i] * u1[i] + u2[i] * u2[i];
        ss += __shfl_xor(ss, 1); ss += __shfl_xor(ss, 2);
        const float rstd = rsqrtf(ss * (1.0f / 64.0f) + EPS);
        const float qs = hs < 2 ? 1.0f : 0.125f;
#pragma unroll
        for (int i = 0; i < 8; ++i) { u1[i] = u1[i] * rstd * gn[d0 + i]; u2[i] = u2[i] * rstd * gn[d0 + 16 + i]; }
        if (row < ML) {
            const int t = row & 2047; const int pos = (p < 2) ? (t >> 6) : 32 + (t & 63);
#pragma unroll
            for (int i = 0; i < 8; ++i) { const int fi = (p & 1) * 8 + i; const float cs = RP[(pos * 16 + fi) * 2], sn = RP[(pos * 16 + fi) * 2 + 1];
                const float o1 = u1[i] * cs - u2[i] * sn, o2 = u2[i] * cs + u1[i] * sn; u1[i] = o1; u2[i] = o2; }
        }
        u32x4 wa, wb;
        wa.x = cvt_pk_bf16(u1[0] * qs, u1[1] * qs); wa.y = cvt_pk_bf16(u1[2] * qs, u1[3] * qs); wa.z = cvt_pk_bf16(u1[4] * qs, u1[5] * qs); wa.w = cvt_pk_bf16(u1[6] * qs, u1[7] * qs);
        wb.x = cvt_pk_bf16(u2[0] * qs, u2[1] * qs); wb.y = cvt_pk_bf16(u2[2] * qs, u2[3] * qs); wb.z = cvt_pk_bf16(u2[4] * qs, u2[5] * qs); wb.w = cvt_pk_bf16(u2[6] * qs, u2[7] * qs);
        *(u32x4*)ptr = wa; *(u32x4*)(ptr + 16) = wb;
    }
}

__device__ __forceinline__ float hgrn_lb(const float* lbl, int l, int dir, int ch) {
    float v[4]; float mx = -1e30f;
#pragma unroll
    for (int j = 0; j < 4; ++j) { v[j] = lbl[(j * 2 + dir) * 512 + ch]; mx = fmaxf(mx, v[j]); }
    float s = 0.f, c = 0.f;
#pragma unroll
    for (int j = 0; j < 4; ++j) { v[j] = __expf(v[j] - mx); s += v[j]; }
#pragma unroll
    for (int j = 1; j < 4; ++j) if (j <= l) c += v[j];
    return c / s;
}

__device__ __forceinline__ int chunk_row0(int b, int dir, int n, int& cid) {
    if (n < 4) { const int cc = dir ? 3 - n : n; cid = cc; return ML + b * 256 + cc * 64; }
    const int lc = dir ? 31 - (n - 4) : (n - 4); cid = 4 + lc; return b * 2048 + lc * 64;
}
__device__ __forceinline__ void scan_unit(LAS unsigned char* lds, const bf16_t* Z1, bf16_t* SS, const float* lbl, int l, int b, int h, int dir, int vq) {
    LAS bf16_t* kT = (LAS bf16_t*)lds;
    LAS bf16_t* vT = (LAS bf16_t*)(lds + 18432);
    LAS float* segtot = (LAS float*)(lds + 18432 + 4608);
    LAS float* dd = segtot + 512;
    const int tid = tid_(), lane = tid & 63, w = tid >> 6, fr = lane & 15, quad = lane >> 4;
    const int seg = tid >> 7, kch = tid & 127;
    const float lb = hgrn_lb(lbl, l, dir, h * 128 + kch), oml = 1.0f - lb;
    const int mt = w & 1, nt0 = (w >> 1) * 2;
    f32x4 S[2]; S[0] = (f32x4){0.f, 0.f, 0.f, 0.f}; S[1] = S[0];
    const int zcol = (dir ? ZFB : ZFF) + h * 128 + kch;
    const int vt = tid >> 3, v4 = (tid & 7) * 4;
    const int vcol = ZI + h * 128 + vq * 32 + v4;
    bf16_t zc[16]; u32x2 vc;
    { int cid; const int r0 = chunk_row0(b, dir, 0, cid);
#pragma unroll
      for (int jj = 0; jj < 16; ++jj) zc[jj] = Z1[(size_t)(r0 + seg * 16 + jj) * ZLD + zcol];
      vc = *(const u32x2*)(Z1 + (size_t)(r0 + vt) * ZLD + vcol); }
    for (int n = 0; n < 36; ++n) {
        int cid; chunk_row0(b, dir, n, cid);
        bf16_t zn[16]; u32x2 vn = vc;
#pragma unroll
        for (int jj = 0; jj < 16; ++jj) zn[jj] = zc[jj];
        if (n + 1 < 36) { int cid2; const int r1 = chunk_row0(b, dir, n + 1, cid2);
#pragma unroll
            for (int jj = 0; jj < 16; ++jj) zn[jj] = Z1[(size_t)(r1 + seg * 16 + jj) * ZLD + zcol];
            vn = *(const u32x2*)(Z1 + (size_t)(r1 + vt) * ZLD + vcol); }
        float lf[16], kk[16], cum[16]; float run = 0.f;
#pragma unroll
        for (int jj = 0; jj < 16; ++jj) { const float s = sigmoidf_(bf2f(zc[jj])); const float f = s + lb * (1.0f - s); lf[jj] = __logf(f); kk[jj] = oml * (1.0f - s); run += lf[jj]; cum[jj] = run; }
        segtot[seg * 128 + kch] = run;
        vT[(v4 + 0) * 72 + vt] = (bf16_t)(vc.x & 0xffffu); vT[(v4 + 1) * 72 + vt] = (bf16_t)(vc.x >> 16);
        vT[(v4 + 2) * 72 + vt] = (bf16_t)(vc.y & 0xffffu); vT[(v4 + 3) * 72 + vt] = (bf16_t)(vc.y >> 16);
        __syncthreads();
        float off = 0.f, total = 0.f;
#pragma unroll
        for (int s = 0; s < 4; ++s) { const float v = segtot[s * 128 + kch]; total += v; if (s < seg) off += v; }
        unsigned pk[8];
#pragma unroll
        for (int jj = 0; jj < 16; jj += 2) {
            const float e0 = dir ? (off + cum[jj] - lf[jj]) : (total - off - cum[jj]);
            const float e1 = dir ? (off + cum[jj + 1] - lf[jj + 1]) : (total - off - cum[jj + 1]);
            pk[jj >> 1] = cvt_pk_bf16(kk[jj] * __expf(e0), kk[jj + 1] * __expf(e1));
        }
        *(LAS u32x4*)(kT + kch * 72 + seg * 16) = (u32x4){pk[0], pk[1], pk[2], pk[3]};
        *(LAS u32x4*)(kT + kch * 72 + seg * 16 + 8) = (u32x4){pk[4], pk[5], pk[6], pk[7]};
        if (seg == 0) dd[kch] = __expf(total);
        { bf16_t* SSb = SS + ((size_t)(((b * 4 + h) * 2 + dir) * 36 + cid) * 128) * 128;
#pragma unroll
          for (int u = 0; u < 2; ++u)
#pragma unroll
              for (int r = 0; r < 4; ++r) SSb[(size_t)(vq * 32 + 16 * mt + quad * 4 + r) * 128 + 16 * (nt0 + u) + fr] = f2bf(S[u][r]); }
        __syncthreads();
        { const float d0 = dd[16 * nt0 + fr], d1 = dd[16 * (nt0 + 1) + fr];
          S[0] = S[0] * d0; S[1] = S[1] * d1;
#pragma unroll
          for (int ks = 0; ks < 2; ++ks) { const bf16x8 av = *(const LAS bf16x8*)(vT + (16 * mt + fr) * 72 + ks * 32 + quad * 8);
#pragma unroll
              for (int u = 0; u < 2; ++u) { const bf16x8 bk = *(const LAS bf16x8*)(kT + (16 * (nt0 + u) + fr) * 72 + ks * 32 + quad * 8);
                  S[u] = __builtin_amdgcn_mfma_f32_16x16x32_bf16(av, bk, S[u], 0, 0, 0); } } }
        __syncthreads();
#pragma unroll
        for (int jj = 0; jj < 16; ++jj) zc[jj] = zn[jj];
        vc = vn;
    }
}

__device__ __forceinline__ void hgrn_out_unit(LAS unsigned char* lds, bf16_t* Z1, const bf16_t* SS, const float* lbl, const float* hng, int l, int b, int h, int cid) {
    LAS bf16_t* qg = (LAS bf16_t*)lds;
    LAS bf16_t* qs = (LAS bf16_t*)(lds + 17408);
    LAS bf16_t* ksame = (LAS bf16_t*)(lds + 2 * 17408);
    LAS bf16_t* kcross = (LAS bf16_t*)(lds + 3 * 17408);
    LAS bf16_t* vT = (LAS bf16_t*)(lds + 3 * 17408 + 8704);
    LAS bf16_t* Ab = (LAS bf16_t*)(lds + 3 * 17408 + 8704 + 18432);
    LAS float* segtot = (LAS float*)(lds + 3 * 17408 + 8704 + 18432 + 9216);
    LAS float* ssq = segtot + 512;
    const int tid = tid_(), lane = tid & 63, w = tid >> 6, fr = lane & 15, quad = lane >> 4;
    const int seg = tid >> 7, kch = tid & 127;
    const int row0 = cid < 4 ? ML + b * 256 + cid * 64 : b * 2048 + (cid - 4) * 64;
    const int mt = w & 3, ntb = (w >> 2) * 4;
    f32x4 o[4];
#pragma unroll
    for (int u = 0; u < 4; ++u) o[u] = (f32x4){0.f, 0.f, 0.f, 0.f};
    { const int t = tid >> 3, v16 = (tid & 7) * 16;
      const u32x4* src = (const u32x4*)(Z1 + (size_t)(row0 + t) * ZLD + ZI + h * 128 + v16);
      const u32x4 x0 = src[0], x1 = src[1];
      const unsigned xs[8] = {x0.x, x0.y, x0.z, x0.w, x1.x, x1.y, x1.z, x1.w};
#pragma unroll
      for (int i = 0; i < 8; ++i) { vT[(v16 + 2 * i) * 72 + t] = (bf16_t)(xs[i] & 0xffffu); vT[(v16 + 2 * i + 1) * 72 + t] = (bf16_t)(xs[i] >> 16); } }
#pragma unroll 1
    for (int dir = 0; dir < 2; ++dir) {
        const float lb = hgrn_lb(lbl, l, dir, h * 128 + kch), oml = 1.0f - lb;
        const int zcol = (dir ? ZFB : ZFF) + h * 128 + kch;
        float lf[16], kk[16], cum[16], qv[16]; float run = 0.f;
#pragma unroll
        for (int jj = 0; jj < 16; ++jj) {
            const size_t rb = (size_t)(row0 + seg * 16 + jj) * ZLD;
            const float z = bf2f(Z1[rb + zcol]); const float qr = bf2f(Z1[rb + ZQH + h * 128 + kch]);
            const float s = sigmoidf_(z); const float f = s + lb * (1.0f - s); lf[jj] = __logf(f); kk[jj] = oml * (1.0f - s); run += lf[jj]; cum[jj] = run;
            qv[jj] = qr * sigmoidf_(qr);
        }
        segtot[seg * 128 + kch] = run;
        __syncthreads();
        float off = 0.f, total = 0.f, G01, G23;
        { const float s0 = segtot[kch], s1 = segtot[128 + kch], s2 = segtot[256 + kch], s3 = segtot[384 + kch];
          total = (s0 + s1) + (s2 + s3); G01 = s0 + s1; G23 = s2 + s3; off = seg == 0 ? 0.f : (seg == 1 ? s0 : (seg == 2 ? s0 + s1 : s0 + s1 + s2)); }
#pragma unroll
        for (int jj = 0; jj < 16; ++jj) {
            const int t = seg * 16 + jj; const float P = off + cum[jj];
            float g, r;
            if (dir == 0) { g = P; r = (t < 32) ? 0.f : G01; } else { g = total - (P - lf[jj]); r = (t >= 32) ? 0.f : G23; }
            qg[t * 136 + kch] = f2bf(qv[jj] * __expf(g));
            qs[t * 136 + kch] = f2bf(qv[jj] * __expf(g - r));
            ksame[t * 136 + kch] = f2bf(kk[jj] * __expf(r - g));
            if (dir == 0) { if (t < 32) kcross[t * 136 + kch] = f2bf(kk[jj] * __expf(G01 - g)); }
            else { if (t >= 32) kcross[(t - 32) * 136 + kch] = f2bf(kk[jj] * __expf(G23 - g)); }
        }
        __syncthreads();
        { const bf16_t* SSb = SS + ((size_t)(((b * 4 + h) * 2 + dir) * 36 + cid) * 128) * 128;
#pragma unroll
          for (int ks = 0; ks < 4; ++ks) { const bf16x8 av = *(const LAS bf16x8*)(qg + (16 * mt + fr) * 136 + ks * 32 + quad * 8);
#pragma unroll
              for (int u = 0; u < 4; ++u) { const bf16x8 bs = *(const bf16x8*)(SSb + (size_t)(16 * (ntb + u) + fr) * 128 + ks * 32 + quad * 8);
                  o[u] = __builtin_amdgcn_mfma_f32_16x16x32_bf16(av, bs, o[u], 0, 0, 0); } } }
        { const int I = w >> 1;
#pragma unroll
          for (int jx = 0; jx < 2; ++jx) { const int J = (w & 1) * 2 + jx;
              const bool zero = dir == 0 ? (J > I) : (J < I);
              f32x4 at = (f32x4){0.f, 0.f, 0.f, 0.f};
              if (!zero) {
                  const bool same = (I >> 1) == (J >> 1);
                  const LAS bf16_t* kb = same ? ksame + 16 * J * 136 : kcross + ((16 * J) & 31) * 136;
#pragma unroll
                  for (int ks = 0; ks < 4; ++ks) { const bf16x8 av = *(const LAS bf16x8*)(qs + (16 * I + fr) * 136 + ks * 32 + quad * 8);
                      const bf16x8 bk = *(const LAS bf16x8*)(kb + fr * 136 + ks * 32 + quad * 8);
                      at = __builtin_amdgcn_mfma_f32_16x16x32_bf16(av, bk, at, 0, 0, 0); }
                  if (I == J) {
#pragma unroll
                      for (int r = 0; r < 4; ++r) { const int tt = quad * 4 + r; const bool keep = dir == 0 ? (fr <= tt) : (fr >= tt); if (!keep) at[r] = 0.f; } }
              }
#pragma unroll
              for (int r = 0; r < 4; ++r) Ab[(16 * I + quad * 4 + r) * 72 + 16 * J + fr] = f2bf(at[r]);
          } }
        __syncthreads();
#pragma unroll
        for (int ks = 0; ks < 2; ++ks) { const bf16x8 av = *(const LAS bf16x8*)(Ab + (16 * mt + fr) * 72 + ks * 32 + quad * 8);
#pragma unroll
            for (int u = 0; u < 4; ++u) { const bf16x8 bv = *(const LAS bf16x8*)(vT + (16 * (ntb + u) + fr) * 72 + ks * 32 + quad * 8);
                o[u] = __builtin_amdgcn_mfma_f32_16x16x32_bf16(av, bv, o[u], 0, 0, 0); } }
        __syncthreads();
    }
    {
        float sq[4];
#pragma unroll
        for (int r = 0; r < 4; ++r) { float s = 0.f;
#pragma unroll
            for (int u = 0; u < 4; ++u) s += o[u][r] * o[u][r];
            s += __shfl_xor(s, 1); s += __shfl_xor(s, 2); s += __shfl_xor(s, 4); s += __shfl_xor(s, 8); sq[r] = s; }
        if (fr == 0) {
#pragma unroll
            for (int r = 0; r < 4; ++r) ssq[(w >> 2) * 64 + 16 * mt + quad * 4 + r] = sq[r]; }
        __syncthreads();
#pragma unroll
        for (int r = 0; r < 4; ++r) { const int t = 16 * mt + quad * 4 + r; const float tot = ssq[t] + ssq[64 + t]; const float rstd = rsqrtf(tot * (1.0f / 128.0f) + EPS);
#pragma unroll
            for (int u = 0; u < 4; ++u) { const int v = 16 * (ntb + u) + fr; bf16_t* gp = Z1 + (size_t)(row0 + t) * ZLD + ZGH + h * 128 + v;
                const float gr = bf2f(*gp); const float y = o[u][r] * rstd * hng[v] * (gr * sigmoidf_(gr)); *gp = f2bf(y); } }
        __syncthreads();
    }
}

__device__ __forceinline__ void attn_unit(LAS unsigned char* lds, bf16_t* Z1, const float* sinkl, int b, int kvh, int qb, bool isctx) {
    LAS bf16_t* Ks = (LAS bf16_t*)lds;
    LAS bf16_t* VT = (LAS bf16_t*)(lds + 18432);
    const int tid = tid_(), lane = tid & 63, w = tid >> 6, fr = lane & 15, quad = lane >> 4;
    const int hq = kvh * 4 + (w >> 1);
    const int qrow0 = (isctx ? ML + b * 256 : b * 2048) + qb * 128 + (w & 1) * 64;
    bf16x8 qf[4][2];
#pragma unroll
    for (int mt = 0; mt < 4; ++mt)
#pragma unroll
        for (int ks = 0; ks < 2; ++ks) qf[mt][ks] = *(const bf16x8*)(Z1 + (size_t)(qrow0 + mt * 16 + fr) * ZLD + ZQ + hq * 64 + ks * 32 + quad * 8);
    f32x4 acc[4][4]; float mrun[4], lrun[4];
    const float sk = sinkl[hq];
#pragma unroll
    for (int mt = 0; mt < 4; ++mt) { mrun[mt] = sk; lrun[mt] = 0.f;
#pragma unroll
        for (int dt = 0; dt < 4; ++dt) acc[mt][dt] = (f32x4){0.f, 0.f, 0.f, 0.f}; }
    const int nblk = isctx ? 2 : 5;
#pragma unroll 1
    for (int kb = 0; kb < nblk; ++kb) {
        int krow0, wtype = 0;
        if (isctx) krow0 = ML + b * 256 + kb * 128;
        else if (kb < 3) { const int nb = qb - 1 + kb; if (nb < 0 || nb > 15) continue; krow0 = b * 2048 + nb * 128; wtype = kb == 0 ? 1 : (kb == 2 ? 2 : 0); }
        else krow0 = ML + b * 256 + (kb - 3) * 128;
        { const int key = tid >> 2, p = tid & 3;
          const u32x4* ksrc = (const u32x4*)(Z1 + (size_t)(krow0 + key) * ZLD + ZK + kvh * 64 + p * 16);
          const u32x4 k0 = ksrc[0], k1 = ksrc[1];
          const u32x4* vsrc = (const u32x4*)(Z1 + (size_t)(krow0 + key) * ZLD + ZV + kvh * 64 + p * 16);
          const u32x4 v0 = vsrc[0], v1 = vsrc[1];
          *(LAS u32x4*)(Ks + key * 72 + p * 16) = k0; *(LAS u32x4*)(Ks + key * 72 + p * 16 + 8) = k1;
          const unsigned vs[8] = {v0.x, v0.y, v0.z, v0.w, v1.x, v1.y, v1.z, v1.w};
#pragma unroll
          for (int i = 0; i < 8; ++i) { VT[(p * 16 + 2 * i) * 136 + key] = (bf16_t)(vs[i] & 0xffffu); VT[(p * 16 + 2 * i + 1) * 136 + key] = (bf16_t)(vs[i] >> 16); } }
        __syncthreads();
#pragma unroll 1
        for (int st = 0; st < 4; ++st) {
            const int kt0 = st * 32;
            bf16x8 ka[2][2];
#pragma unroll
            for (int u = 0; u < 2; ++u)
#pragma unroll
                for (int ks = 0; ks < 2; ++ks) ka[u][ks] = *(const LAS bf16x8*)(Ks + (kt0 + 16 * u + fr) * 72 + ks * 32 + quad * 8);
            bf16x8 va[4];
#pragma unroll
            for (int dt = 0; dt < 4; ++dt) { const u32x2 lo = *(const LAS u32x2*)(VT + (16 * dt + fr) * 136 + kt0 + quad * 4); const u32x2 hi = *(const LAS u32x2*)(VT + (16 * dt + fr) * 136 + kt0 + 16 + quad * 4);
                const u32x4 c4 = (u32x4){lo.x, lo.y, hi.x, hi.y}; va[dt] = __builtin_bit_cast(bf16x8, c4); }
#pragma unroll
            for (int mt = 0; mt < 4; ++mt) {
                f32x4 s0 = (f32x4){0.f, 0.f, 0.f, 0.f}, s1 = s0;
                s0 = __builtin_amdgcn_mfma_f32_16x16x32_bf16(ka[0][0], qf[mt][0], s0, 0, 0, 0); s0 = __builtin_amdgcn_mfma_f32_16x16x32_bf16(ka[0][1], qf[mt][1], s0, 0, 0, 0);
                s1 = __builtin_amdgcn_mfma_f32_16x16x32_bf16(ka[1][0], qf[mt][0], s1, 0, 0, 0); s1 = __builtin_amdgcn_mfma_f32_16x16x32_bf16(ka[1][1], qf[mt][1], s1, 0, 0, 0);
                if (wtype) { const int trel = (w & 1) * 64 + mt * 16 + fr;
#pragma unroll
                    for (int r = 0; r < 4; ++r) { const int k0r = kt0 + quad * 4 + r, k1r = k0r + 16;
                        const bool v0ok = wtype == 1 ? (k0r >= trel) : (k0r <= trel); const bool v1ok = wtype == 1 ? (k1r >= trel) : (k1r <= trel);
                        if (!v0ok) s0[r] = -1e30f; if (!v1ok) s1[r] = -1e30f; } }
                float mx = fmaxf(fmaxf(fmaxf(s0[0], s0[1]), fmaxf(s0[2], s0[3])), fmaxf(fmaxf(s1[0], s1[1]), fmaxf(s1[2], s1[3])));
                mx = fmaxf(mx, __shfl_xor(mx, 16)); mx = fmaxf(mx, __shfl_xor(mx, 32));
                const float mn = fmaxf(mrun[mt], mx); const float alpha = __expf(mrun[mt] - mn); mrun[mt] = mn;
                float ps = 0.f;
#pragma unroll
                for (int r = 0; r < 4; ++r) { s0[r] = __expf(s0[r] - mn); s1[r] = __expf(s1[r] - mn); ps += s0[r] + s1[r]; }
                lrun[mt] = lrun[mt] * alpha + ps;
                const u32x4 pp = (u32x4){cvt_pk_bf16(s0[0], s0[1]), cvt_pk_bf16(s0[2], s0[3]), cvt_pk_bf16(s1[0], s1[1]), cvt_pk_bf16(s1[2], s1[3])};
                const bf16x8 pf = __builtin_bit_cast(bf16x8, pp);
#pragma unroll
                for (int dt = 0; dt < 4; ++dt) { acc[mt][dt] = acc[mt][dt] * alpha; acc[mt][dt] = __builtin_amdgcn_mfma_f32_16x16x32_bf16(va[dt], pf, acc[mt][dt], 0, 0, 0); }
            }
        }
        __syncthreads();
    }
#pragma unroll
    for (int mt = 0; mt < 4; ++mt) {
        float lt = lrun[mt]; lt += __shfl_xor(lt, 16); lt += __shfl_xor(lt, 32); lt += __expf(sk - mrun[mt]);
        const float inv = 1.0f / lt;
#pragma unroll
        for (int dt = 0; dt < 4; ++dt) { const f32x4 ov = acc[mt][dt] * inv; u32x2 wv; wv.x = cvt_pk_bf16(ov[0], ov[1]); wv.y = cvt_pk_bf16(ov[2], ov[3]);
            *(u32x2*)(Z1 + (size_t)(qrow0 + mt * 16 + fr) * ZLD + ZQ + hq * 64 + 16 * dt + quad * 4) = wv; }
    }
}

__global__ void __launch_bounds__(NT, 2) fwd_kernel(Args a_) {
    extern __shared__ __attribute__((aligned(16))) unsigned char lds_raw[];
    LAS unsigned char* lds = (LAS unsigned char*)lds_raw;
    cg::grid_group grid = cg::this_grid();
    ArgsP a = (ArgsP)__builtin_amdgcn_kernarg_segment_ptr();
#define RELOAD() asm volatile("" : "+s"(a) :: "memory"); unsigned char* ws = a->ws; const int G = gridDim.x, c = blockIdx.x; bf16_t* Z1 = (bf16_t*)(ws + WS_Z1); bf16_t* SS = (bf16_t*)(ws + WS_SS); const float* lbl = a->in[12]; (void)G; (void)c; (void)Z1; (void)SS; (void)lbl

    PH(0) { RELOAD(); prologue(a, lds); }
    grid.sync();
#pragma unroll 1
    for (int l = 0; l < DEPTH; ++l) {
        PH(1) { RELOAD(); if (l > 0) convert_weights(a, l, lds);
        norm_phase(a, l, 0); }
        grid.sync();
        PH(2) { RELOAD(); SchedInproj S{(const char*)(ws + WS_H), (const char*)(ws + WS_W1T), (const char*)(ws + WS_W2T), G, c};
          EpiInproj E{Z1, (bf16_t*)(ws + WS_PQ)};
          pg8::gemm_phase<EpiInproj, SchedInproj, false>(lds, D, S, E); }
        grid.sync();
        {
          PH(3) { RELOAD(); SchedPlain S{(const char*)(ws + WS_FT), (const char*)(ws + WS_PQ), 4096, 4096, 8, 16, G, c};
            EpiFourier E{(bf16_t*)(ws + WS_H)};
            pg8::gemm_phase<EpiFourier, SchedPlain, false>(lds, 4096, S, E); }
          PH(4) { RELOAD(); const int c2 = (c >= 128) ? c - 128 : c + G;
            SchedCtx S{(const char*)(ws + WS_FC), (const char*)(ws + WS_PQ + PQ_CTX_OFF), G, c2};
            EpiFourier E{(bf16_t*)(ws + WS_H)};
            pg8::gemm_phase<EpiFourier, SchedCtx, false>(lds, 512, S, E); }
          PH(5) { RELOAD(); qkprep_phase(a, l); }
          PH(6) { RELOAD(); const int half = G >= 2 ? G / 2 : 1; for (int s = 0; s < 256; ++s) { if (G - 1 - (s % half) != c) continue;
              scan_unit(lds, Z1, SS, lbl, l, s >> 5, (s >> 3) & 3, (s >> 2) & 1, s & 3); } }
        }
        grid.sync();
        { RELOAD(); const float* sinkl = a->in[11] + l * 8; const float* hng = a->in[13] + l * 128;
          for (int u = c; u < 288 + 1152; u += G) {
              PH(7) if (u < 288) { if (u < 256) attn_unit(lds, Z1, sinkl, u >> 5, (u >> 4) & 1, u & 15, false);
              else { const int v = u - 256; attn_unit(lds, Z1, sinkl, v >> 2, (v >> 1) & 1, v & 1, true); } }
              PH(8) if (u >= 288) { const int v = u - 288; hgrn_out_unit(lds, Z1, SS, lbl, hng, l, v / 144, (v / 36) & 3, v % 36); }
          } }
        grid.sync();
        PH(9) { RELOAD(); SchedBranch S{(const char*)(ws + WS_H), (const char*)(ws + WS_Z1), (const char*)(ws + WS_WBT), G, c};
          EpiBranch E{Z1, (float*)(ws + WS_SS), (bf16_t*)(ws + WS_PQ)};
          pg8::gemm_phase<EpiBranch, SchedBranch, true>(lds, 512, S, E); }
        grid.sync();
        PH(10) { RELOAD(); SchedPlain S{(const char*)(ws + WS_PQ), (const char*)(ws + WS_WOT), D, D, 72, 4, G, c};
          EpiResid E{a->out, (float*)(ws + WS_XC), (const float*)(ws + WS_MOD) + (size_t)l * 9 * 6144, 2};
          pg8::gemm_phase<EpiResid, SchedPlain, false>(lds, D, S, E); }
        grid.sync();
        PH(11) { RELOAD(); norm_phase(a, l, 1); }
        grid.sync();
        PH(12) { RELOAD(); SchedPlain S{(const char*)(ws + WS_H), (const char*)(ws + WS_WF1T), D, D, 72, 16, G, c};
          EpiRelu2 E{(bf16_t*)(ws + WS_Z1)};
          pg8::gemm_phase<EpiRelu2, SchedPlain, false>(lds, D, S, E); }
        grid.sync();
        PH(13) { RELOAD(); SchedPlain S{(const char*)(ws + WS_Z1), (const char*)(ws + WS_WF2T), DFF, DFF, 72, 4, G, c};
          EpiResid E{a->out, (float*)(ws + WS_XC), (const float*)(ws + WS_MOD) + (size_t)l * 9 * 6144, 5};
          pg8::gemm_phase<EpiResid, SchedPlain, false>(lds, DFF, S, E); }
        grid.sync();
    }
}

extern "C" void kernel_launch(void* const* d_in, const int* in_sizes, int n_in, void* d_out, int out_size, void* d_ws, size_t ws_size, hipStream_t stream) {
    static int grid = 0;
    if (grid == 0) {
        if (n_in != 18 || out_size != ML * D || ws_size < WS_END) { fprintf(stderr, "kernel_launch: unexpected shapes (n_in %d out %d ws %zu need %zu)\n", n_in, out_size, ws_size, (size_t)WS_END); grid = -1; return; }
        int dev = 0, cus = 0, per_cu = 0;
        (void)hipGetDevice(&dev);
        (void)hipDeviceGetAttribute(&cus, hipDeviceAttributeMultiprocessorCount, dev);
        (void)hipFuncSetAttribute((const void*)fwd_kernel, hipFuncAttributeMaxDynamicSharedMemorySize, LDS_BYTES);
        (void)hipOccupancyMaxActiveBlocksPerMultiprocessor(&per_cu, (const void*)fwd_kernel, NT, LDS_BYTES);
        if (per_cu < 1) per_cu = 1;
        if (per_cu > 1) per_cu = 1;
        grid = cus * per_cu;
    }
    if (grid < 0) return;
    Args a{};
    for (int i = 0; i < 18; ++i) a.in[i] = (const float*)d_in[i];
    a.out = (float*)d_out; a.ws = (unsigned char*)d_ws;
    void* args[] = {&a};
    hipError_t e = hipLaunchCooperativeKernel((void*)fwd_kernel, dim3(grid), dim3(NT), args, LDS_BYTES, stream);
    if (e != hipSuccess) fprintf(stderr, "cooperative launch failed: %s (grid %d)\n", hipGetErrorString(e), grid);
}
```
